# Optimizing an MI355X kernel written in HIP

```python
import jax, jax.numpy as jnp
from jax import lax
import numpy as np

D_MODEL = 1024
BATCH = 8
SEQ = 8192
DEPTH = 1
DEC_BATCH = 32
DEC_SEQ = 2048
PAST_LEN = 128

MIX_WIDTH = D_MODEL
W_A = MIX_WIDTH // 2
W_B = MIX_WIDTH - W_A
HEAD_DIM = 64
N_HEADS_A = W_A // HEAD_DIM
N_HEADS_B = W_B // HEAD_DIM
CONV_A = 3
CONV_B = 31
RMS_EPS = 1e-6
LN_EPS = 1e-5
IN_COLS = 4 * W_A + 3 * W_B
SPLITS = (W_A, 2 * W_A, 3 * W_A, 4 * W_A, 4 * W_A + W_B, 4 * W_A + 2 * W_B)

kernel_name = "hybrid_gated_conv_conformer_encoder"


def rmsnorm(x, g):
    xf = x.astype(jnp.float32)
    y = xf * lax.rsqrt(jnp.mean(xf * xf, axis=-1, keepdims=True) + RMS_EPS)
    return (y * g.astype(jnp.float32)).astype(x.dtype)


def dwconv(x, w):
    k = w.shape[0]
    pad = k // 2
    return lax.conv_general_dilated(
        x, w[:, None, :].astype(x.dtype), window_strides=(1,), padding=[(pad, pad)],
        dimension_numbers=("NWC", "WIO", "NWC"), feature_group_count=x.shape[-1])


def head_layernorm(x, g, b):
    bsz, L, _ = x.shape
    xf = x.astype(jnp.float32).reshape(bsz, L, N_HEADS_B, HEAD_DIM)
    mu = jnp.mean(xf, axis=-1, keepdims=True)
    var = jnp.mean(jnp.square(xf - mu), axis=-1, keepdims=True)
    y = ((xf - mu) * lax.rsqrt(var + LN_EPS)).reshape(bsz, L, W_B)
    return (y * g.astype(jnp.float32) + b.astype(jnp.float32)).astype(x.dtype)


def mixer_layer(x, c, norm_g, w_ada, b_ada, w_in, conv_a_w, conv_b_w, conv_b_b, ln_g, ln_b, w_out):
    mod = jax.nn.silu(c) @ w_ada + b_ada
    shift, scale, gate = jnp.split(mod, 3, axis=-1)
    h = rmsnorm(x, norm_g) * (1.0 + scale[:, None, :]) + shift[:, None, :]
    p = h @ w_in
    a_in, a_b, a_c, a_z, b_v, b_g, b_z = jnp.split(p, SPLITS, axis=-1)
    y_a = a_b * dwconv(a_c * a_in, conv_a_w) * jax.nn.silu(a_z)
    u = b_v * jax.nn.sigmoid(b_g)
    u = dwconv(u, conv_b_w) + conv_b_b
    y_b = jax.nn.silu(head_layernorm(u, ln_g, ln_b)) * jax.nn.silu(b_z)
    y = jnp.concatenate([y_a, y_b], axis=-1) @ w_out
    return x + gate[:, None, :] * y


def run_trunk(x, c, norm_g, w_ada, b_ada, w_in, conv_a_w, conv_b_w, conv_b_b, ln_g, ln_b, w_out, final_g):
    for l in range(DEPTH):
        x = mixer_layer(x, c, norm_g[l], w_ada[l], b_ada[l], w_in[l], conv_a_w[l],
                        conv_b_w[l], conv_b_b[l], ln_g[l], ln_b[l], w_out[l])
    return rmsnorm(x, final_g)


def setup_inputs(seed: int = 0) -> dict:
    key = jax.random.key(seed)
    ks = jax.random.split(key, 16)
    f32 = jnp.float32
    D = D_MODEL
    x_prompt = jax.random.normal(ks[0], (BATCH, SEQ, D), f32)
    x_sample = jax.random.normal(ks[1], (DEC_BATCH, DEC_SEQ, D), f32)
    c_prompt = jax.random.normal(ks[2], (BATCH, D), f32)
    c_sample = jax.random.normal(ks[3], (DEC_BATCH, D), f32)
    norm_g = 1.0 + 0.02 * jax.random.normal(ks[4], (DEPTH, D), f32)
    w_ada = jax.random.normal(ks[5], (DEPTH, D, 3 * D), f32) * (D ** -0.5)
    b_ada = 0.02 * jax.random.normal(ks[6], (DEPTH, 3 * D), f32)
    w_in = jax.random.normal(ks[7], (DEPTH, D, IN_COLS), f32) * (D ** -0.5)
    conv_a_w = jax.random.normal(ks[8], (DEPTH, CONV_A, W_A), f32) * (CONV_A ** -0.5)
    conv_b_w = jax.random.normal(ks[9], (DEPTH, CONV_B, W_B), f32) * (CONV_B ** -0.5)
    conv_b_b = 0.02 * jax.random.normal(ks[10], (DEPTH, W_B), f32)
    ln_g = 1.0 + 0.02 * jax.random.normal(ks[11], (DEPTH, W_B), f32)
    ln_b = 0.02 * jax.random.normal(ks[12], (DEPTH, W_B), f32)
    w_out = jax.random.normal(ks[13], (DEPTH, MIX_WIDTH, D), f32) * (MIX_WIDTH ** -0.5)
    final_g = 1.0 + 0.02 * jax.random.normal(ks[14], (D,), f32)
    return {"x_prompt": x_prompt, "x_sample": x_sample, "c_prompt": c_prompt, "c_sample": c_sample,
            "norm_g": norm_g, "w_ada": w_ada, "b_ada": b_ada, "w_in": w_in,
            "conv_a_w": conv_a_w, "conv_b_w": conv_b_w, "conv_b_b": conv_b_b,
            "ln_g": ln_g, "ln_b": ln_b, "w_out": w_out, "final_g": final_g}


def reference(x_prompt, x_sample, c_prompt, c_sample, norm_g, w_ada, b_ada, w_in,
              conv_a_w, conv_b_w, conv_b_b, ln_g, ln_b, w_out, final_g):
    y_prompt = run_trunk(x_prompt, c_prompt, norm_g, w_ada, b_ada, w_in, conv_a_w,
                         conv_b_w, conv_b_b, ln_g, ln_b, w_out, final_g)
    y_sample = run_trunk(x_sample, c_sample, norm_g, w_ada, b_ada, w_in, conv_a_w,
                         conv_b_w, conv_b_b, ln_g, ln_b, w_out, final_g)
    return (y_prompt, y_sample)
```

```cpp
#include <hip/hip_runtime.h>
#include <hip/hip_cooperative_groups.h>
#include <cstdio>
namespace cg = cooperative_groups;

#define LAS __attribute__((address_space(3)))
typedef unsigned short bf16_t;
typedef short bf16x8 __attribute__((ext_vector_type(8)));
typedef float f32x4 __attribute__((ext_vector_type(4)));
typedef float f32x2 __attribute__((ext_vector_type(2)));
typedef unsigned u32x4 __attribute__((ext_vector_type(4)));
typedef unsigned u32x2 __attribute__((ext_vector_type(2)));

constexpr int D = 1024, T_TOK = 131072, T_PROMPT = 65536, NB = 40, INC = 3584;
constexpr int BM = 256, BK = 64, HALF = 128, HTB = HALF * BK * 2, STAGE_BYTES = 8 * HTB, NXCD = 8, WGM = 8;
constexpr int LDS_BYTES = 139264;

constexpr size_t WS_BT1 = 0;
constexpr size_t WS_BT2 = WS_BT1 + (size_t)INC * D * 2;
constexpr size_t WS_MODP = WS_BT2 + (size_t)D * D * 2;
constexpr size_t WS_GATE = WS_MODP + (size_t)4 * NB * 3072 * 4;
constexpr size_t WS_H = WS_GATE + (size_t)NB * D * 4;
constexpr size_t WS_G = WS_H + (size_t)T_TOK * D * 2;
constexpr size_t WS_Y = WS_G + (size_t)T_TOK * 2048 * 2;
constexpr size_t WS_END = WS_Y + (size_t)T_TOK * D * 2;

struct Params {
    const float *xp, *xs, *cp, *cs, *norm_g, *w_ada, *b_ada, *w_in, *conv_a, *conv_b, *conv_bb, *ln_g, *ln_b, *w_out, *final_g;
    float* out; unsigned char* ws;
};

__device__ __forceinline__ unsigned pk_bf16(float lo, float hi) { unsigned r; asm("v_cvt_pk_bf16_f32 %0, %1, %2" : "=v"(r) : "v"(lo), "v"(hi)); return r; }
__device__ __forceinline__ f32x2 unpk_bf16(unsigned w) { f32x2 r; r.x = __uint_as_float(w << 16); r.y = __uint_as_float(w & 0xffff0000u); return r; }
__device__ __forceinline__ float sigmoid_f(float v) { return __builtin_amdgcn_rcpf(1.0f + __expf(-v)); }
__device__ __forceinline__ float silu_f(float v) { return v * sigmoid_f(v); }
__device__ __forceinline__ float wave_sum(float v) {
#pragma unroll
    for (int o = 1; o < 64; o <<= 1) v += __shfl_xor(v, o);
    return v;
}

__host__ __device__ __forceinline__ int lds_byte(int r, int c) { const int st = (r >> 4) * 2 + (c >> 5), rr = r & 15, cc = c & 31, ob = rr * 64 + cc * 2; return st * 1024 + (ob ^ (((ob >> 9) & 1) << 5)); }
__host__ __device__ __forceinline__ void stage_rc(int b, int& R, int& C) { const int st = b / 1024, sb = b % 1024, swz = sb ^ (((sb >> 9) & 1) << 5); R = (st >> 1) * 16 + swz / 64; C = (st & 1) * 32 + (swz % 64) / 2; }

struct Unit { int pm, pn; };
struct Gemm { const bf16_t* A; const bf16_t* Bt; int M, N, K; };

struct StaticOrder {
    int nM, nN, nwg, G, c;
    __device__ void init(int M, int N, int G_, int c_) { nM = M / BM; nN = N / BM; nwg = nM * nN; G = G_; c = c_; }
    __device__ bool next(int i, Unit& u) const {
        const long L = (long)i * G + c; if (L >= nwg) return false;
        int wgid = (int)L; { const int q = nwg / NXCD, r = nwg % NXCD, xcd = wgid % NXCD, off = wgid / NXCD; wgid = (xcd < r ? xcd * (q + 1) : r * (q + 1) + (xcd - r) * q) + off; }
        const int nig = WGM * nN, gid = wgid / nig, fm = gid * WGM, gsz = (nM - fm) < WGM ? (nM - fm) : WGM;
        u.pm = fm + ((wgid % nig) % gsz); u.pn = (wgid % nig) / gsz; return true;
    }
};
struct PanelOrder {
    int nP, G, c;
    __device__ bool next(int i, Unit& u) const { const int panel = (i >> 2) * G + c; if (panel >= nP) return false; u.pm = panel; u.pn = i & 3; return true; }
};

template <class Epi, class Sched>
__device__ __forceinline__ void gemm_phase(LAS unsigned char* lds, const Gemm g, const Sched& S, Epi& E) {
    const int tid = threadIdx.x, wid = __builtin_amdgcn_readfirstlane(tid >> 6), lane = tid & 63, wr = wid >> 2, wc = wid & 3, fr = lane & 15, fq = lane >> 4;
    const int K = g.K, nt = K / BK;
    unsigned voffA[2];
#pragma unroll
    for (int i = 0; i < 2; ++i) { int R, C; stage_rc(tid * 16 + i * 8192, R, C); voffA[i] = (unsigned)(R * K + C) * 2u; }
    const size_t kstep = (size_t)(BK * 2);
    const size_t hstep = (size_t)HALF * K * 2;
    const size_t tstep = 2 * hstep;
    const unsigned ldsw = (unsigned)wid * 1024u;
    const int aoff = lds_byte(wr * 64 + fr, fq * 8), boff = lds_byte(wc * 32 + fr, fq * 8);
#define PG8_SA(b, h) (((b) * 2 + (h)) * HTB)
#define PG8_SB(b, h) ((4 + (b) * 2 + (h)) * HTB)
#define PG8_STAGE(bufoff, gbase, voff) do { _Pragma("unroll") for (int _i = 0; _i < 2; ++_i) \
        __builtin_amdgcn_global_load_lds((const unsigned*)((const char*)(gbase) + (voff)[_i]), (LAS unsigned*)(lds + (bufoff) + ldsw + _i * 8192), 16, 0, 0); } while (0)
#define PG8_LDA(dst, b, h) do { _Pragma("unroll") for (int m = 0; m < 4; ++m) _Pragma("unroll") for (int k = 0; k < 2; ++k) dst[m][k] = *(const LAS bf16x8*)(lds + PG8_SA(b, h) + aoff + m * 2048 + k * 1024); } while (0)
#define PG8_LDB(dst, b, h) do { _Pragma("unroll") for (int n = 0; n < 2; ++n) _Pragma("unroll") for (int k = 0; k < 2; ++k) dst[n][k] = *(const LAS bf16x8*)(lds + PG8_SB(b, h) + boff + n * 2048 + k * 1024); } while (0)
#define PG8_MMA(ai, bj, At, Bt) do { __builtin_amdgcn_s_setprio(1); _Pragma("unroll") for (int m = 0; m < 4; ++m) _Pragma("unroll") for (int n = 0; n < 2; ++n) _Pragma("unroll") for (int k = 0; k < 2; ++k) \
        acc[ai][bj][m][n] = __builtin_amdgcn_mfma_f32_16x16x32_bf16(Bt[n][k], At[m][k], acc[ai][bj][m][n], 0, 0, 0); __builtin_amdgcn_s_setprio(0); } while (0)
#define PG8_WAIT_V(n) asm volatile("s_waitcnt vmcnt(" #n ")" ::: "memory")
#define PG8_WAIT_L(n) asm volatile("s_waitcnt lgkmcnt(" #n ")" ::: "memory")
#define PG8_BAR __builtin_amdgcn_s_barrier()
#define PG8_SCHED __builtin_amdgcn_sched_barrier(0)
    Unit cur, nxt; int ui = 0;
    if (!S.next(0, cur)) return;
    f32x4 acc[2][2][4][2];
#pragma unroll
    for (int a = 0; a < 2; ++a)
#pragma unroll
        for (int b = 0; b < 2; ++b)
#pragma unroll
            for (int m = 0; m < 4; ++m)
#pragma unroll
                for (int n = 0; n < 2; ++n) acc[a][b][m][n] = (f32x4){0.f, 0.f, 0.f, 0.f};
    bf16x8 At[4][2], B0[2][2], B1[2][2];
    const char* cA = (const char*)g.A + (size_t)cur.pm * tstep; const char* cB = (const char*)g.Bt + (size_t)cur.pn * tstep;
    PG8_STAGE(PG8_SB(0, 0), cB, voffA); PG8_STAGE(PG8_SA(0, 0), cA, voffA); PG8_STAGE(PG8_SB(0, 1), cB + hstep, voffA); PG8_STAGE(PG8_SA(0, 1), cA + hstep, voffA);
    if (wr == 1) PG8_BAR;
    PG8_WAIT_V(4); PG8_BAR;
    PG8_STAGE(PG8_SB(1, 0), cB + kstep, voffA); PG8_STAGE(PG8_SA(1, 0), cA + kstep, voffA); PG8_STAGE(PG8_SB(1, 1), cB + hstep + kstep, voffA);
    PG8_WAIT_V(6); PG8_BAR;
    for (;;) {
        const bool has_next = S.next(ui + 1, nxt);
        const char* nA = has_next ? (const char*)g.A + (size_t)nxt.pm * tstep : cA; const char* nB = has_next ? (const char*)g.Bt + (size_t)nxt.pn * tstep : cB;
        for (int t = 0; t < nt; t += 2) {
            const bool last = (t == nt - 2);
            const char* a1 = cA + (size_t)(t + 1) * kstep;
            const char* a2 = last ? nA : cA + (size_t)(t + 2) * kstep; const char* b2 = last ? nB : cB + (size_t)(t + 2) * kstep;
            const char* a3 = a2 + kstep; const char* b3 = b2 + kstep;
            PG8_LDB(B0, 0, 0); PG8_SCHED; PG8_LDA(At, 0, 0); PG8_STAGE(PG8_SA(1, 1), a1 + hstep, voffA);
            PG8_WAIT_L(8); PG8_BAR; PG8_WAIT_L(0); PG8_MMA(0, 0, At, B0); PG8_BAR; PG8_SCHED;
            PG8_LDB(B1, 0, 1); PG8_STAGE(PG8_SB(0, 0), b2, voffA);
            PG8_BAR; PG8_WAIT_L(0); PG8_MMA(0, 1, At, B1); PG8_BAR;
            PG8_LDA(At, 0, 1); PG8_STAGE(PG8_SA(0, 0), a2, voffA);
            PG8_BAR; PG8_WAIT_L(0); PG8_MMA(1, 0, At, B0); PG8_BAR; PG8_SCHED;
            PG8_STAGE(PG8_SB(0, 1), b2 + hstep, voffA);
            PG8_WAIT_V(6); PG8_BAR; PG8_MMA(1, 1, At, B1); PG8_BAR;
            PG8_LDB(B0, 1, 0); PG8_SCHED; PG8_LDA(At, 1, 0); PG8_STAGE(PG8_SA(0, 1), a2 + hstep, voffA);
            PG8_WAIT_L(8); PG8_BAR; PG8_WAIT_L(0); PG8_MMA(0, 0, At, B0); PG8_BAR; PG8_SCHED;
            PG8_LDB(B1, 1, 1); PG8_STAGE(PG8_SB(1, 0), b3, voffA);
            PG8_BAR; PG8_WAIT_L(0); PG8_MMA(0, 1, At, B1); PG8_BAR;
            PG8_LDA(At, 1, 1); PG8_STAGE(PG8_SA(1, 0), a3, voffA);
            PG8_BAR; PG8_WAIT_L(0); PG8_MMA(1, 0, At, B0); PG8_BAR; PG8_SCHED;
            PG8_STAGE(PG8_SB(1, 1), b3 + hstep, voffA);
            PG8_WAIT_V(6); PG8_BAR; PG8_MMA(1, 1, At, B1); PG8_BAR;
        }
        E(acc, cur, wr, wc, fr, fq, wid, lane);
        if (!has_next) break;
#pragma unroll
        for (int a = 0; a < 2; ++a)
#pragma unroll
            for (int b = 0; b < 2; ++b)
#pragma unroll
                for (int m = 0; m < 4; ++m)
#pragma unroll
                    for (int n = 0; n < 2; ++n) acc[a][b][m][n] = (f32x4){0.f, 0.f, 0.f, 0.f};
        cur = nxt; cA = nA; cB = nB; ++ui;
    }
    PG8_WAIT_V(0);
    if (wr == 0) PG8_BAR;
    PG8_BAR;
}

struct EpiGate {
    bf16_t* G;
    __device__ __forceinline__ void operator()(const f32x4 (&acc)[2][2][4][2], const Unit& u, int wr, int wc, int fr, int fq, int, int) {
        const int row0 = u.pm * BM + wr * 64 + fr;
        if (u.pn < 8) {
            const int ch = u.pn * 64 + wc * 16 + fq * 4;
#pragma unroll
            for (int ai = 0; ai < 2; ++ai)
#pragma unroll
                for (int m = 0; m < 4; ++m) {
                    bf16_t* rp = G + (size_t)(row0 + ai * HALF + m * 16) * 2048 + ch;
                    const f32x4 vin = acc[ai][0][m][0], vb = acc[ai][0][m][1], vc = acc[ai][1][m][0], vz = acc[ai][1][m][1];
                    f32x4 q = vc * vin, gg;
#pragma unroll
                    for (int j = 0; j < 4; ++j) gg[j] = vb[j] * silu_f(vz[j]);
                    u32x2 wq, wg; wq.x = pk_bf16(q[0], q[1]); wq.y = pk_bf16(q[2], q[3]); wg.x = pk_bf16(gg[0], gg[1]); wg.y = pk_bf16(gg[2], gg[3]);
                    *(u32x2*)rp = wq; *(u32x2*)(rp + 512) = wg;
                }
        } else if (u.pn < 12) {
#pragma unroll
            for (int ai = 0; ai < 2; ++ai)
#pragma unroll
                for (int m = 0; m < 4; ++m)
#pragma unroll
                    for (int bj = 0; bj < 2; ++bj) {
                        const int ch = (u.pn - 8) * 128 + bj * 64 + wc * 16 + fq * 4;
                        const f32x4 v = acc[ai][bj][m][0], gt = acc[ai][bj][m][1]; f32x4 uu;
#pragma unroll
                        for (int j = 0; j < 4; ++j) uu[j] = v[j] * sigmoid_f(gt[j]);
                        u32x2 w; w.x = pk_bf16(uu[0], uu[1]); w.y = pk_bf16(uu[2], uu[3]);
                        *(u32x2*)(G + (size_t)(row0 + ai * HALF + m * 16) * 2048 + 1024 + ch) = w;
                    }
        } else {
#pragma unroll
            for (int ai = 0; ai < 2; ++ai)
#pragma unroll
                for (int m = 0; m < 4; ++m)
#pragma unroll
                    for (int bj = 0; bj < 2; ++bj) {
                        const int ch = (u.pn - 12) * 256 + bj * 128 + wc * 32 + fq * 8;
                        const f32x4 z0 = acc[ai][bj][m][0], z1 = acc[ai][bj][m][1]; f32x4 s0, s1;
#pragma unroll
                        for (int j = 0; j < 4; ++j) { s0[j] = silu_f(z0[j]); s1[j] = silu_f(z1[j]); }
                        u32x4 w; w.x = pk_bf16(s0[0], s0[1]); w.y = pk_bf16(s0[2], s0[3]); w.z = pk_bf16(s1[0], s1[1]); w.w = pk_bf16(s1[2], s1[3]);
                        *(u32x4*)(G + (size_t)(row0 + ai * HALF + m * 16) * 2048 + 1536 + ch) = w;
                    }
        }
    }
};
__device__ __forceinline__ int bt1_row(int col) {
    int pn, bj, wc, n, fq, j;
    if (col < 2048) { const int role = col >> 9, ch = col & 511; pn = ch >> 6; const int cl = ch & 63; wc = cl >> 4; fq = (cl >> 2) & 3; j = cl & 3; bj = role >> 1; n = role & 1; }
    else if (col < 3072) { const int role = (col - 2048) >> 9, ch = col & 511; pn = 8 + (ch >> 7); const int cl = ch & 127; bj = cl >> 6; wc = (cl >> 4) & 3; fq = (cl >> 2) & 3; j = cl & 3; n = role; }
    else { const int ch = col - 3072; pn = 12 + (ch >> 8); const int cl = ch & 255; bj = cl >> 7; wc = (cl >> 5) & 3; fq = (cl >> 3) & 3; n = (cl >> 2) & 1; j = cl & 3; }
    return pn * 256 + bj * 128 + wc * 32 + n * 16 + fq * 4 + j;
}

struct EpiOut {
    const float *xp, *xs, *gate, *fg; float* out; LAS float* red; float ssq[2][4];
    __device__ __forceinline__ void operator()(const f32x4 (&acc)[2][2][4][2], const Unit& u, int wr, int wc, int fr, int fq, int wid, int lane) {
        const int prow = u.pm * BM; const int bb = prow < T_PROMPT ? (prow >> 13) : 8 + ((prow - T_PROMPT) >> 11);
        const float* xb = prow < T_PROMPT ? xp + (size_t)prow * D : xs + (size_t)(prow - T_PROMPT) * D;
        float* ob = out + (size_t)prow * D;
        const int col0 = u.pn * BM + wc * 32 + fq * 4;
        if (u.pn == 0) {
#pragma unroll
            for (int a = 0; a < 2; ++a)
#pragma unroll
                for (int m = 0; m < 4; ++m) ssq[a][m] = 0.f;
        }
        f32x4 gv[2][2];
#pragma unroll
        for (int bj = 0; bj < 2; ++bj)
#pragma unroll
            for (int n = 0; n < 2; ++n) gv[bj][n] = *(const f32x4*)(gate + bb * D + col0 + bj * HALF + n * 16);
#pragma unroll
        for (int ai = 0; ai < 2; ++ai)
#pragma unroll
            for (int m = 0; m < 4; ++m) {
                const int lr = ai * HALF + wr * 64 + m * 16 + fr;
                const float* xr = xb + (size_t)lr * D + col0; float* orow = ob + (size_t)lr * D + col0;
                f32x4 xv[2][2];
#pragma unroll
                for (int bj = 0; bj < 2; ++bj)
#pragma unroll
                    for (int n = 0; n < 2; ++n) xv[bj][n] = *(const f32x4*)(xr + bj * HALF + n * 16);
                float s = ssq[ai][m];
#pragma unroll
                for (int bj = 0; bj < 2; ++bj)
#pragma unroll
                    for (int n = 0; n < 2; ++n) { const f32x4 z = xv[bj][n] + gv[bj][n] * acc[ai][bj][m][n]; *(f32x4*)(orow + bj * HALF + n * 16) = z; s += (z[0] * z[0] + z[1] * z[1]) + (z[2] * z[2] + z[3] * z[3]); }
                ssq[ai][m] = s;
            }
        if (u.pn == 3) {
#pragma unroll
            for (int ai = 0; ai < 2; ++ai)
#pragma unroll
                for (int m = 0; m < 4; ++m) { float s = ssq[ai][m]; s += __shfl_xor(s, 16); s += __shfl_xor(s, 32); if (fq == 0) red[(ai * HALF + wr * 64 + m * 16 + fr) * 4 + wc] = s; }
            __builtin_amdgcn_fence(__ATOMIC_RELEASE, "workgroup");
            asm volatile("s_waitcnt vmcnt(0) lgkmcnt(0)" ::: "memory");
            __builtin_amdgcn_s_barrier(); asm volatile("" ::: "memory");
            __builtin_amdgcn_s_barrier(); asm volatile("" ::: "memory");
            __builtin_amdgcn_fence(__ATOMIC_ACQUIRE, "workgroup");
            const f32x4* fg4 = (const f32x4*)fg;
            f32x4 fgv[4];
#pragma unroll
            for (int j = 0; j < 4; ++j) fgv[j] = fg4[lane + 64 * j];
            for (int i = 0; i < 32; i += 2) {
                const int lr = wid * 32 + i;
                f32x4* o0 = (f32x4*)(ob + (size_t)lr * D); f32x4* o1 = o0 + 256;
                f32x4 v0[4], v1[4];
#pragma unroll
                for (int j = 0; j < 4; ++j) { v0[j] = o0[lane + 64 * j]; v1[j] = o1[lane + 64 * j]; }
                const f32x4 r0 = *(const LAS f32x4*)(red + lr * 4), r1 = *(const LAS f32x4*)(red + lr * 4 + 4);
                const float rs0 = rsqrtf(((r0[0] + r0[1]) + (r0[2] + r0[3])) * (1.0f / D) + 1e-6f), rs1 = rsqrtf(((r1[0] + r1[1]) + (r1[2] + r1[3])) * (1.0f / D) + 1e-6f);
#pragma unroll
                for (int j = 0; j < 4; ++j) { o0[lane + 64 * j] = v0[j] * rs0 * fgv[j]; o1[lane + 64 * j] = v1[j] * rs1 * fgv[j]; }
            }
        }
    }
};

__device__ __forceinline__ void p0_mod_item(const Params& p, LAS unsigned char* lds, int item) {
    const int tid = threadIdx.x, wid = tid >> 6, lane = tid & 63;
    const int cgp = item >> 2, kc = item & 3;
    LAS float* s = (LAS float*)lds;
    LAS float* wp = (LAS float*)(lds + 40960);
    for (int idx = tid; idx < NB * 256; idx += 512) {
        const int b = idx >> 8, kk = idx & 255;
        const float c = b < 8 ? p.cp[b * D + kc * 256 + kk] : p.cs[(b - 8) * D + kc * 256 + kk];
        s[kk * NB + b] = silu_f(c);
    }
    __syncthreads();
    const int col = cgp * 64 + lane;
    const float* wbase = p.w_ada + (size_t)(kc * 256 + wid * 32) * 3072 + col;
    float wv[32];
#pragma unroll
    for (int kk = 0; kk < 32; ++kk) wv[kk] = wbase[(size_t)kk * 3072];
    float acc[NB];
#pragma unroll
    for (int b = 0; b < NB; ++b) acc[b] = 0.f;
#pragma unroll
    for (int kk = 0; kk < 32; ++kk) {
        const LAS f32x4* sr = (const LAS f32x4*)(s + (wid * 32 + kk) * NB);
#pragma unroll
        for (int b4 = 0; b4 < NB / 4; ++b4) { const f32x4 sv = sr[b4];
            acc[b4 * 4 + 0] += sv[0] * wv[kk]; acc[b4 * 4 + 1] += sv[1] * wv[kk]; acc[b4 * 4 + 2] += sv[2] * wv[kk]; acc[b4 * 4 + 3] += sv[3] * wv[kk]; }
    }
#pragma unroll
    for (int b = 0; b < NB; ++b) wp[(wid * NB + b) * 64 + lane] = acc[b];
    __syncthreads();
    float* modp = (float*)(p.ws + WS_MODP);
    for (int idx = tid; idx < NB * 64; idx += 512) {
        const int b = idx >> 6, l = idx & 63; float t = 0.f;
#pragma unroll
        for (int w = 0; w < 8; ++w) t += wp[(w * NB + b) * 64 + l];
        modp[((size_t)kc * NB + b) * 3072 + cgp * 64 + l] = t;
    }
}
template <bool PERM>
__device__ __forceinline__ void p0_transpose_item(const float* W, int N, bf16_t* Bt, LAS unsigned char* lds, int item) {
    const int tid = threadIdx.x; const int nct = N >> 6, kb = item / nct, cb = item % nct, k0 = kb * 64, c0 = cb * 64;
    LAS float* tile = (LAS float*)lds;
#pragma unroll
    for (int i = 0; i < 8; ++i) { const int idx = i * 512 + tid, kk = idx >> 6, cc = idx & 63; tile[kk * 65 + cc] = W[(size_t)(k0 + kk) * N + c0 + cc]; }
    __syncthreads();
#pragma unroll
    for (int i = 0; i < 4; ++i) { const int idx = i * 512 + tid, cc = idx >> 5, kp = idx & 31;
        const int col = c0 + cc, row = PERM ? bt1_row(col) : col;
        *(unsigned*)(Bt + (size_t)row * D + k0 + 2 * kp) = pk_bf16(tile[(2 * kp) * 65 + cc], tile[(2 * kp + 1) * 65 + cc]); }
}
__device__ __forceinline__ void phase0(const Params& p, LAS unsigned char* lds) {
    constexpr int N_MOD = 192, N_T1 = 16 * (INC / 64), N_T2 = 16 * (D / 64);
    for (int it = blockIdx.x; it < N_MOD + N_T1 + N_T2; it += gridDim.x) {
        if (it < N_MOD) p0_mod_item(p, lds, it);
        else if (it < N_MOD + N_T1) p0_transpose_item<true>(p.w_in, INC, (bf16_t*)(p.ws + WS_BT1), lds, it - N_MOD);
        else p0_transpose_item<false>(p.w_out, D, (bf16_t*)(p.ws + WS_BT2), lds, it - N_MOD - N_T1);
        __syncthreads();
    }
}

__device__ __forceinline__ void phase1(const Params& p, LAS unsigned char* lds) {
    const int tid = threadIdx.x, wid = tid >> 6, lane = tid & 63;
    LAS float* cA = (LAS float*)lds; LAS float* cB = cA + D;
    const float* modp = (const float*)(p.ws + WS_MODP);
    float* gate = (float*)(p.ws + WS_GATE);
    bf16_t* H = (bf16_t*)(p.ws + WS_H);
    for (int chunk = blockIdx.x; chunk < T_TOK / 512; chunk += gridDim.x) {
        const int row0 = chunk * 512;
        const int bb = row0 < T_PROMPT ? (row0 >> 13) : 8 + ((row0 - T_PROMPT) >> 11);
        const bool first = row0 < T_PROMPT ? ((row0 & 8191) == 0) : (((row0 - T_PROMPT) & 2047) == 0);
        __syncthreads();
        for (int j = tid; j < D; j += 512) {
            float sh = p.b_ada[j], sc = p.b_ada[D + j];
#pragma unroll
            for (int q = 0; q < 4; ++q) { sh += modp[((size_t)q * NB + bb) * 3072 + j]; sc += modp[((size_t)q * NB + bb) * 3072 + D + j]; }
            cA[j] = p.norm_g[j] * (1.0f + sc); cB[j] = sh;
            if (first) { float gt = p.b_ada[2 * D + j];
#pragma unroll
                for (int q = 0; q < 4; ++q) gt += modp[((size_t)q * NB + bb) * 3072 + 2 * D + j];
                gate[bb * D + j] = gt; }
        }
        __syncthreads();
        const float* xb = row0 < T_PROMPT ? p.xp + (size_t)row0 * D : p.xs + (size_t)(row0 - T_PROMPT) * D;
        f32x4 a4[4], b4[4];
#pragma unroll
        for (int j = 0; j < 4; ++j) { a4[j] = *(const LAS f32x4*)(cA + (lane + 64 * j) * 4); b4[j] = *(const LAS f32x4*)(cB + (lane + 64 * j) * 4); }
        for (int r = 0; r < 64; r += 2) {
            const int lr = wid * 64 + r;
            const f32x4* x0 = (const f32x4*)(xb + (size_t)lr * D); const f32x4* x1 = x0 + 256;
            f32x4 v0[4], v1[4]; float s0 = 0.f, s1 = 0.f;
#pragma unroll
            for (int j = 0; j < 4; ++j) { v0[j] = x0[lane + 64 * j]; v1[j] = x1[lane + 64 * j]; }
#pragma unroll
            for (int j = 0; j < 4; ++j) { s0 += (v0[j][0] * v0[j][0] + v0[j][1] * v0[j][1]) + (v0[j][2] * v0[j][2] + v0[j][3] * v0[j][3]); s1 += (v1[j][0] * v1[j][0] + v1[j][1] * v1[j][1]) + (v1[j][2] * v1[j][2] + v1[j][3] * v1[j][3]); }
            const float rs0 = rsqrtf(wave_sum(s0) * (1.0f / D) + 1e-6f), rs1 = rsqrtf(wave_sum(s1) * (1.0f / D) + 1e-6f);
            u32x2* h0 = (u32x2*)(H + (size_t)(row0 + lr) * D); u32x2* h1 = h0 + 256;
#pragma unroll
            for (int j = 0; j < 4; ++j) {
                const f32x4 y0 = v0[j] * rs0 * a4[j] + b4[j], y1 = v1[j] * rs1 * a4[j] + b4[j];
                u32x2 w0, w1; w0.x = pk_bf16(y0[0], y0[1]); w0.y = pk_bf16(y0[2], y0[3]); w1.x = pk_bf16(y1[0], y1[1]); w1.y = pk_bf16(y1[2], y1[3]);
                h0[lane + 64 * j] = w0; h1[lane + 64 * j] = w1;
            }
        }
    }
}

constexpr int TR = 16;
constexpr int TT = 2 * TR;
__device__ __forceinline__ void phase3(const Params& p, LAS unsigned char* lds) {
    const int tid = threadIdx.x, wid = tid >> 6, lane = tid & 63;
    const unsigned* Gu = (const unsigned*)(p.ws + WS_G);
    unsigned* Yu = (unsigned*)(p.ws + WS_Y);
    const int cgp = wid & 3, th = wid >> 2, dcol = cgp * 64 + lane, chB = 2 * dcol;
    f32x2 wB[31];
#pragma unroll
    for (int k = 0; k < 31; ++k) wB[k] = *(const f32x2*)(p.conv_b + k * 512 + chB);
    const f32x2 bias = *(const f32x2*)(p.conv_bb + chB), lg = *(const f32x2*)(p.ln_g + chB), lb = *(const f32x2*)(p.ln_b + chB);
    LAS f32x2* st = (LAS f32x2*)(lds + wid * (TR * 66 * 8));
    LAS f32x2* ms = (LAS f32x2*)(lds + 8 * (TR * 66 * 8) + wid * 512);
    const int dcA = tid & 255, thA = tid >> 8, chA = 2 * dcA;
    const f32x2 wa0 = *(const f32x2*)(p.conv_a + chA), wa1 = *(const f32x2*)(p.conv_a + 512 + chA), wa2 = *(const f32x2*)(p.conv_a + 1024 + chA);
    for (int tile = blockIdx.x; tile < T_TOK / TT; tile += gridDim.x) {
        const int t0 = tile * TT;
        const int L = t0 < T_PROMPT ? 8192 : 2048, seq_lo = t0 & ~(L - 1), seq_hi = seq_lo + L;
        {
            const int tb = t0 + th * TR;
            unsigned uw[TR + 30];
#pragma unroll
            for (int i = 0; i < TR + 30; ++i) { const int tok = tb - 15 + i; uw[i] = (tok >= seq_lo && tok < seq_hi) ? Gu[(size_t)tok * 1024 + 512 + dcol] : 0u; }
            f32x2 cb[TR];
#pragma unroll
            for (int i = 0; i < TR; ++i) {
                f32x2 a = bias;
#pragma unroll
                for (int k = 0; k < 31; ++k) a = __builtin_elementwise_fma(wB[k], unpk_bf16(uw[i + k]), a);
                cb[i] = a;
            }
#pragma unroll
            for (int i = 0; i < TR; ++i) { f32x2 sq; sq.x = cb[i].x + cb[i].y; sq.y = cb[i].x * cb[i].x + cb[i].y * cb[i].y; st[i * 66 + lane] = sq; }
            asm volatile("s_waitcnt lgkmcnt(0)" ::: "memory");
            {
                const int tk = lane & (TR - 1), hd = (lane >> 5);
                const LAS f32x4* rp = (const LAS f32x4*)(st + tk * 66 + hd * 32);
                float S = 0.f, Q = 0.f;
#pragma unroll
                for (int e = 0; e < 16; ++e) { const f32x4 v = rp[e]; S += v[0] + v[2]; Q += v[1] + v[3]; }
                const float mean = S * (1.0f / 64.0f), var = Q * (1.0f / 64.0f) - mean * mean;
                f32x2 mr; mr.x = mean; mr.y = rsqrtf(fmaxf(var, 0.f) + 1e-5f);
                if ((lane & 31) < TR) ms[hd * 32 + tk] = mr;
            }
            asm volatile("s_waitcnt lgkmcnt(0)" ::: "memory");
#pragma unroll
            for (int i = 0; i < TR; ++i) {
                const int tok = tb + i;
                const f32x2 mr = ms[(lane >> 5) * 32 + i];
                const f32x2 szv = unpk_bf16(Gu[(size_t)tok * 1024 + 768 + dcol]);
                f32x2 y = (cb[i] - mr.x) * mr.y * lg + lb;
                y.x = silu_f(y.x) * szv.x; y.y = silu_f(y.y) * szv.y;
                Yu[(size_t)tok * 512 + 256 + dcol] = pk_bf16(y.x, y.y);
            }
            asm volatile("s_waitcnt lgkmcnt(0)" ::: "memory");
        }
        {
            const int tb = t0 + thA * TR;
            unsigned qw[TR + 2];
#pragma unroll
            for (int i = 0; i < TR + 2; ++i) { const int tok = tb - 1 + i; qw[i] = (tok >= seq_lo && tok < seq_hi) ? Gu[(size_t)tok * 1024 + dcA] : 0u; }
#pragma unroll
            for (int i = 0; i < TR; ++i) {
                const int tok = tb + i;
                const f32x2 gg = unpk_bf16(Gu[(size_t)tok * 1024 + 256 + dcA]);
                const f32x2 cv = wa0 * unpk_bf16(qw[i]) + wa1 * unpk_bf16(qw[i + 1]) + wa2 * unpk_bf16(qw[i + 2]);
                const f32x2 y = gg * cv;
                Yu[(size_t)tok * 512 + dcA] = pk_bf16(y.x, y.y);
            }
        }
    }
}

__global__ void __launch_bounds__(512, 2) fwd_kernel(Params p) {
    extern __shared__ __attribute__((aligned(16))) unsigned char shm[];
    LAS unsigned char* lds = (LAS unsigned char*)shm;
    cg::grid_group grid = cg::this_grid();
    phase0(p, lds);
    grid.sync();
    phase1(p, lds);
    grid.sync();
    {
        Gemm g; g.A = (const bf16_t*)(p.ws + WS_H); g.Bt = (const bf16_t*)(p.ws + WS_BT1); g.M = T_TOK; g.N = INC; g.K = D;
        StaticOrder S; S.init(T_TOK, INC, (int)gridDim.x, (int)blockIdx.x);
        EpiGate E; E.G = (bf16_t*)(p.ws + WS_G);
        gemm_phase(lds, g, S, E);
    }
    grid.sync();
    phase3(p, lds);
    grid.sync();
    {
        Gemm g; g.A = (const bf16_t*)(p.ws + WS_Y); g.Bt = (const bf16_t*)(p.ws + WS_BT2); g.M = T_TOK; g.N = D; g.K = D;
        PanelOrder S; S.nP = T_TOK / BM; S.G = (int)gridDim.x; S.c = (int)blockIdx.x;
        EpiOut E; E.xp = p.xp; E.xs = p.xs; E.gate = (const float*)(p.ws + WS_GATE); E.fg = p.final_g; E.out = p.out; E.red = (LAS float*)(lds + STAGE_BYTES);
        gemm_phase(lds, g, S, E);
    }
}

extern "C" void kernel_launch(void* const* d_in, const int* in_sizes, int n_in, void* d_out, int out_size, void* d_ws, size_t ws_size, hipStream_t stream) {
    static int grid_blocks = 0;
    if (grid_blocks == 0) {
        if (n_in != 15 || ws_size < WS_END) { fprintf(stderr, "kernel_launch: unexpected n_in %d / ws_size %zu (need %zu)\n", n_in, ws_size, (size_t)WS_END); grid_blocks = -1; return; }
        int dev = 0, cus = 0, per_cu = 0;
        (void)hipGetDevice(&dev);
        (void)hipDeviceGetAttribute(&cus, hipDeviceAttributeMultiprocessorCount, dev);
        if (hipFuncSetAttribute((const void*)fwd_kernel, hipFuncAttributeMaxDynamicSharedMemorySize, LDS_BYTES) != hipSuccess) { fprintf(stderr, "kernel_launch: hipFuncSetAttribute failed\n"); grid_blocks = -1; return; }
        if (hipOccupancyMaxActiveBlocksPerMultiprocessor(&per_cu, (const void*)fwd_kernel, 512, LDS_BYTES) != hipSuccess || per_cu < 1) { fprintf(stderr, "kernel_launch: occupancy query failed (%d)\n", per_cu); (void)hipGetLastError(); per_cu = 1; }
        grid_blocks = cus * 1;
        fprintf(stderr, "kernel_launch: cus %d per_cu %d grid %d\n", cus, per_cu, grid_blocks);
    }
    if (grid_blocks < 0) return;
    Params p{};
    p.xp = (const float*)d_in[0]; p.xs = (const float*)d_in[1]; p.cp = (const float*)d_in[2]; p.cs = (const float*)d_in[3];
    p.norm_g = (const float*)d_in[4]; p.w_ada = (const float*)d_in[5]; p.b_ada = (const float*)d_in[6]; p.w_in = (const float*)d_in[7];
    p.conv_a = (const float*)d_in[8]; p.conv_b = (const float*)d_in[9]; p.conv_bb = (const float*)d_in[10]; p.ln_g = (const float*)d_in[11];
    p.ln_b = (const float*)d_in[12]; p.w_out = (const float*)d_in[13]; p.final_g = (const float*)d_in[14];
    p.out = (float*)d_out; p.ws = (unsigned char*)d_ws;
    void* args[] = {&p};
    hipError_t e = hipLaunchCooperativeKernel((const void*)fwd_kernel, dim3(grid_blocks), dim3(512), args, LDS_BYTES, stream);
    if (e != hipSuccess) fprintf(stderr, "cooperative launch failed: %s (grid %d)\n", hipGetErrorString(e), grid_blocks);
}
```

```cpp
#include <hip/hip_runtime.h>
#include <hip/hip_cooperative_groups.h>
#include <cstdio>
namespace cg = cooperative_groups;

#define LAS __attribute__((address_space(3)))
typedef unsigned short bf16_t;
typedef short bf16x8 __attribute__((ext_vector_type(8)));
typedef float f32x4 __attribute__((ext_vector_type(4)));
typedef float f32x2 __attribute__((ext_vector_type(2)));
typedef unsigned u32x4 __attribute__((ext_vector_type(4)));
typedef unsigned u32x2 __attribute__((ext_vector_type(2)));

#ifndef REP_P1
#define REP_P1 1
#endif
#ifndef REP_P2
#define REP_P2 1
#endif
#ifndef REP_P3
#define REP_P3 1
#endif
#ifndef REP_P4
#define REP_P4 1
#endif
constexpr int D = 1024, T_TOK = 131072, T_PROMPT = 65536, NB = 40, INC = 3584;
constexpr int BM = 256, BK = 64, HALF = 128, HTB = HALF * BK * 2, STAGE_BYTES = 8 * HTB, NXCD = 8, WGM = 8;
constexpr int LDS_BYTES = 139264;

constexpr size_t WS_BT1 = 0;
constexpr size_t WS_BT2 = WS_BT1 + (size_t)INC * D * 2;
constexpr size_t WS_MODP = WS_BT2 + (size_t)D * D * 2;
constexpr size_t WS_GATE = WS_MODP + (size_t)4 * NB * 3072 * 4;
constexpr size_t WS_H = WS_GATE + (size_t)NB * D * 4;
constexpr size_t WS_G = WS_H + (size_t)T_TOK * D * 2;
constexpr size_t WS_Y = WS_G + (size_t)T_TOK * 2048 * 2;
constexpr size_t WS_END = WS_Y + (size_t)T_TOK * D * 2;

struct Params {
    const float *xp, *xs, *cp, *cs, *norm_g, *w_ada, *b_ada, *w_in, *conv_a, *conv_b, *conv_bb, *ln_g, *ln_b, *w_out, *final_g;
    float* out; unsigned char* ws;
};

__device__ __forceinline__ unsigned pk_bf16(float lo, float hi) { unsigned r; asm("v_cvt_pk_bf16_f32 %0, %1, %2" : "=v"(r) : "v"(lo), "v"(hi)); return r; }
__device__ __forceinline__ f32x2 unpk_bf16(unsigned w) { f32x2 r; r.x = __uint_as_float(w << 16); r.y = __uint_as_float(w & 0xffff0000u); return r; }
__device__ __forceinline__ float sigmoid_f(float v) { return __builtin_amdgcn_rcpf(1.0f + __expf(-v)); }
__device__ __forceinline__ float silu_f(float v) { return v * sigmoid_f(v); }
__device__ __forceinline__ float wave_sum(float v) {
#pragma unroll
    for (int o = 1; o < 64; o <<= 1) v += __shfl_xor(v, o);
    return v;
}

__host__ __device__ __forceinline__ int lds_byte(int r, int c) { const int st = (r >> 4) * 2 + (c >> 5), rr = r & 15, cc = c & 31, ob = rr * 64 + cc * 2; return st * 1024 + (ob ^ (((ob >> 9) & 1) << 5)); }
__host__ __device__ __forceinline__ void stage_rc(int b, int& R, int& C) { const int st = b / 1024, sb = b % 1024, swz = sb ^ (((sb >> 9) & 1) << 5); R = (st >> 1) * 16 + swz / 64; C = (st & 1) * 32 + (swz % 64) / 2; }

struct Unit { int pm, pn; };
struct Gemm { const bf16_t* A; const bf16_t* Bt; int M, N, K; };

struct StaticOrder {
    int nM, nN, nwg, G, c;
    __device__ void init(int M, int N, int G_, int c_) { nM = M / BM; nN = N / BM; nwg = nM * nN; G = G_; c = c_; }
    __device__ bool next(int i, Unit& u) const {
        const long L = (long)i * G + c; if (L >= (long)REP_P2 * nwg) return false;
        int wgid = (int)(L % nwg); { const int q = nwg / NXCD, r = nwg % NXCD, xcd = wgid % NXCD, off = wgid / NXCD; wgid = (xcd < r ? xcd * (q + 1) : r * (q + 1) + (xcd - r) * q) + off; }
        const int nig = WGM * nN, gid = wgid / nig, fm = gid * WGM, gsz = (nM - fm) < WGM ? (nM - fm) : WGM;
        u.pm = fm + ((wgid % nig) % gsz); u.pn = (wgid % nig) / gsz; return true;
    }
};
struct PanelOrder {
    int nP, G, c;
    __device__ bool next(int i, Unit& u) const { const int panel_ = (i >> 2) * G + c; if (panel_ >= REP_P4 * nP) return false; const int panel = panel_ % nP; u.pm = panel; u.pn = i & 3; return true; }
};

template <class Epi, class Sched>
__device__ __forceinline__ void gemm_phase(LAS unsigned char* lds, const Gemm g, const Sched& S, Epi& E) {
    const int tid = threadIdx.x, wid = __builtin_amdgcn_readfirstlane(tid >> 6), lane = tid & 63, wr = wid >> 2, wc = wid & 3, fr = lane & 15, fq = lane >> 4;
    const int K = g.K, nt = K / BK;
    unsigned voffA[2];
#pragma unroll
    for (int i = 0; i < 2; ++i) { int R, C; stage_rc(tid * 16 + i * 8192, R, C); voffA[i] = (unsigned)(R * K + C) * 2u; }
    const size_t kstep = (size_t)(BK * 2);
    const size_t hstep = (size_t)HALF * K * 2;
    const size_t tstep = 2 * hstep;
    const unsigned ldsw = (unsigned)wid * 1024u;
    const int aoff = lds_byte(wr * 64 + fr, fq * 8), boff = lds_byte(wc * 32 + fr, fq * 8);
#define PG8_SA(b, h) (((b) * 2 + (h)) * HTB)
#define PG8_SB(b, h) ((4 + (b) * 2 + (h)) * HTB)
#define PG8_STAGE(bufoff, gbase, voff) do { _Pragma("unroll") for (int _i = 0; _i < 2; ++_i) \
        __builtin_amdgcn_global_load_lds((const unsigned*)((const char*)(gbase) + (voff)[_i]), (LAS unsigned*)(lds + (bufoff) + ldsw + _i * 8192), 16, 0, 0); } while (0)
#define PG8_LDA(dst, b, h) do { _Pragma("unroll") for (int m = 0; m < 4; ++m) _Pragma("unroll") for (int k = 0; k < 2; ++k) dst[m][k] = *(const LAS bf16x8*)(lds + PG8_SA(b, h) + aoff + m * 2048 + k * 1024); } while (0)
#define PG8_LDB(dst, b, h) do { _Pragma("unroll") for (int n = 0; n < 2; ++n) _Pragma("unroll") for (int k = 0; k < 2; ++k) dst[n][k] = *(const LAS bf16x8*)(lds + PG8_SB(b, h) + boff + n * 2048 + k * 1024); } while (0)
#define PG8_MMA(ai, bj, At, Bt) do { __builtin_amdgcn_s_setprio(1); _Pragma("unroll") for (int m = 0; m < 4; ++m) _Pragma("unroll") for (int n = 0; n < 2; ++n) _Pragma("unroll") for (int k = 0; k < 2; ++k) \
        acc[ai][bj][m][n] = __builtin_amdgcn_mfma_f32_16x16x32_bf16(Bt[n][k], At[m][k], acc[ai][bj][m][n], 0, 0, 0); __builtin_amdgcn_s_setprio(0); } while (0)
#define PG8_WAIT_V(n) asm volatile("s_waitcnt vmcnt(" #n ")" ::: "memory")
#define PG8_WAIT_L(n) asm volatile("s_waitcnt lgkmcnt(" #n ")" ::: "memory")
#define PG8_BAR __builtin_amdgcn_s_barrier()
#define PG8_SCHED __builtin_amdgcn_sched_barrier(0)
    Unit cur, nxt; int ui = 0;
    if (!S.next(0, cur)) return;
    f32x4 acc[2][2][4][2];
#pragma unroll
    for (int a = 0; a < 2; ++a)
#pragma unroll
        for (int b = 0; b < 2; ++b)
#pragma unroll
            for (int m = 0; m < 4; ++m)
#pragma unroll
                for (int n = 0; n < 2; ++n) acc[a][b][m][n] = (f32x4){0.f, 0.f, 0.f, 0.f};
    bf16x8 At[4][2], B0[2][2], B1[2][2];
    const char* cA = (const char*)g.A + (size_t)cur.pm * tstep; const char* cB = (const char*)g.Bt + (size_t)cur.pn * tstep;
    PG8_STAGE(PG8_SB(0, 0), cB, voffA); PG8_STAGE(PG8_SA(0, 0), cA, voffA); PG8_STAGE(PG8_SB(0, 1), cB + hstep, voffA); PG8_STAGE(PG8_SA(0, 1), cA + hstep, voffA);
    if (wr == 1) PG8_BAR;
    PG8_WAIT_V(4); PG8_BAR;
    PG8_STAGE(PG8_SB(1, 0), cB + kstep, voffA); PG8_STAGE(PG8_SA(1, 0), cA + kstep, voffA); PG8_STAGE(PG8_SB(1, 1), cB + hstep + kstep, voffA);
    PG8_WAIT_V(6); PG8_BAR;
    for (;;) {
        const bool has_next = S.next(ui + 1, nxt);
        const char* nA = has_next ? (const char*)g.A + (size_t)nxt.pm * tstep : cA; const char* nB = has_next ? (const char*)g.Bt + (size_t)nxt.pn * tstep : cB;
        for (int t = 0; t < nt; t += 2) {
            const bool last = (t == nt - 2);
            const char* a1 = cA + (size_t)(t + 1) * kstep;
            const char* a2 = last ? nA : cA + (size_t)(t + 2) * kstep; const char* b2 = last ? nB : cB + (size_t)(t + 2) * kstep;
            const char* a3 = a2 + kstep; const char* b3 = b2 + kstep;
            PG8_LDB(B0, 0, 0); PG8_SCHED; PG8_LDA(At, 0, 0); PG8_STAGE(PG8_SA(1, 1), a1 + hstep, voffA);
            PG8_WAIT_L(8); PG8_BAR; PG8_WAIT_L(0); PG8_MMA(0, 0, At, B0); PG8_BAR; PG8_SCHED;
            PG8_LDB(B1, 0, 1); PG8_STAGE(PG8_SB(0, 0), b2, voffA);
            PG8_BAR; PG8_WAIT_L(0); PG8_MMA(0, 1, At, B1); PG8_BAR;
            PG8_LDA(At, 0, 1); PG8_STAGE(PG8_SA(0, 0), a2, voffA);
            PG8_BAR; PG8_WAIT_L(0); PG8_MMA(1, 0, At, B0); PG8_BAR; PG8_SCHED;
            PG8_STAGE(PG8_SB(0, 1), b2 + hstep, voffA);
            PG8_WAIT_V(6); PG8_BAR; PG8_MMA(1, 1, At, B1); PG8_BAR;
            PG8_LDB(B0, 1, 0); PG8_SCHED; PG8_LDA(At, 1, 0); PG8_STAGE(PG8_SA(0, 1), a2 + hstep, voffA);
            PG8_WAIT_L(8); PG8_BAR; PG8_WAIT_L(0); PG8_MMA(0, 0, At, B0); PG8_BAR; PG8_SCHED;
            PG8_LDB(B1, 1, 1); PG8_STAGE(PG8_SB(1, 0), b3, voffA);
            PG8_BAR; PG8_WAIT_L(0); PG8_MMA(0, 1, At, B1); PG8_BAR;
            PG8_LDA(At, 1, 1); PG8_STAGE(PG8_SA(1, 0), a3, voffA);
            PG8_BAR; PG8_WAIT_L(0); PG8_MMA(1, 0, At, B0); PG8_BAR; PG8_SCHED;
            PG8_STAGE(PG8_SB(1, 1), b3 + hstep, voffA);
            PG8_WAIT_V(6); PG8_BAR; PG8_MMA(1, 1, At, B1); PG8_BAR;
        }
        E(acc, cur, wr, wc, fr, fq, wid, lane);
        if (!has_next) break;
#pragma unroll
        for (int a = 0; a < 2; ++a)
#pragma unroll
            for (int b = 0; b < 2; ++b)
#pragma unroll
                for (int m = 0; m < 4; ++m)
#pragma unroll
                    for (int n = 0; n < 2; ++n) acc[a][b][m][n] = (f32x4){0.f, 0.f, 0.f, 0.f};
        cur = nxt; cA = nA; cB = nB; ++ui;
    }
    PG8_WAIT_V(0);
    if (wr == 0) PG8_BAR;
    PG8_BAR;
}

struct EpiGate {
    bf16_t* G;
    __device__ __forceinline__ void operator()(const f32x4 (&acc)[2][2][4][2], const Unit& u, int wr, int wc, int fr, int fq, int, int) {
        const int row0 = u.pm * BM + wr * 64 + fr;
        if (u.pn < 8) {
            const int ch = u.pn * 64 + wc * 16 + fq * 4;
#pragma unroll
            for (int ai = 0; ai < 2; ++ai)
#pragma unroll
                for (int m = 0; m < 4; ++m) {
                    bf16_t* rp = G + (size_t)(row0 + ai * HALF + m * 16) * 2048 + ch;
                    const f32x4 vin = acc[ai][0][m][0], vb = acc[ai][0][m][1], vc = acc[ai][1][m][0], vz = acc[ai][1][m][1];
                    f32x4 q = vc * vin, gg;
#pragma unroll
                    for (int j = 0; j < 4; ++j) gg[j] = vb[j] * silu_f(vz[j]);
                    u32x2 wq, wg; wq.x = pk_bf16(q[0], q[1]); wq.y = pk_bf16(q[2], q[3]); wg.x = pk_bf16(gg[0], gg[1]); wg.y = pk_bf16(gg[2], gg[3]);
                    *(u32x2*)rp = wq; *(u32x2*)(rp + 512) = wg;
                }
        } else if (u.pn < 12) {
#pragma unroll
            for (int ai = 0; ai < 2; ++ai)
#pragma unroll
                for (int m = 0; m < 4; ++m)
#pragma unroll
                    for (int bj = 0; bj < 2; ++bj) {
                        const int ch = (u.pn - 8) * 128 + bj * 64 + wc * 16 + fq * 4;
                        const f32x4 v = acc[ai][bj][m][0], gt = acc[ai][bj][m][1]; f32x4 uu;
#pragma unroll
                        for (int j = 0; j < 4; ++j) uu[j] = v[j] * sigmoid_f(gt[j]);
                        u32x2 w; w.x = pk_bf16(uu[0], uu[1]); w.y = pk_bf16(uu[2], uu[3]);
                        *(u32x2*)(G + (size_t)(row0 + ai * HALF + m * 16) * 2048 + 1024 + ch) = w;
                    }
        } else {
#pragma unroll
            for (int ai = 0; ai < 2; ++ai)
#pragma unroll
                for (int m = 0; m < 4; ++m)
#pragma unroll
                    for (int bj = 0; bj < 2; ++bj) {
                        const int ch = (u.pn - 12) * 256 + bj * 128 + wc * 32 + fq * 8;
                        const f32x4 z0 = acc[ai][bj][m][0], z1 = acc[ai][bj][m][1]; f32x4 s0, s1;
#pragma unroll
                        for (int j = 0; j < 4; ++j) { s0[j] = silu_f(z0[j]); s1[j] = silu_f(z1[j]); }
                        u32x4 w; w.x = pk_bf16(s0[0], s0[1]); w.y = pk_bf16(s0[2], s0[3]); w.z = pk_bf16(s1[0], s1[1]); w.w = pk_bf16(s1[2], s1[3]);
                        *(u32x4*)(G + (size_t)(row0 + ai * HALF + m * 16) * 2048 + 1536 + ch) = w;
                    }
        }
    }
};
__device__ __forceinline__ int bt1_row(int col) {
    int pn, bj, wc, n, fq, j;
    if (col < 2048) { const int role = col >> 9, ch = col & 511; pn = ch >> 6; const int cl = ch & 63; wc = cl >> 4; fq = (cl >> 2) & 3; j = cl & 3; bj = role >> 1; n = role & 1; }
    else if (col < 3072) { const int role = (col - 2048) >> 9, ch = col & 511; pn = 8 + (ch >> 7); const int cl = ch & 127; bj = cl >> 6; wc = (cl >> 4) & 3; fq = (cl >> 2) & 3; j = cl & 3; n = role; }
    else { const int ch = col - 3072; pn = 12 + (ch >> 8); const int cl = ch & 255; bj = cl >> 7; wc = (cl >> 5) & 3; fq = (cl >> 3) & 3; n = (cl >> 2) & 1; j = cl & 3; }
    return pn * 256 + bj * 128 + wc * 32 + n * 16 + fq * 4 + j;
}

struct EpiOut {
    const float *xp, *xs, *gate, *fg; float* out; LAS float* red; float ssq[2][4];
    __device__ __forceinline__ void operator()(const f32x4 (&acc)[2][2][4][2], const Unit& u, int wr, int wc, int fr, int fq, int wid, int lane) {
        const int prow = u.pm * BM; const int bb = prow < T_PROMPT ? (prow >> 13) : 8 + ((prow - T_PROMPT) >> 11);
        const float* xb = prow < T_PROMPT ? xp + (size_t)prow * D : xs + (size_t)(prow - T_PROMPT) * D;
        float* ob = out + (size_t)prow * D;
        const int col0 = u.pn * BM + wc * 32 + fq * 4;
        if (u.pn == 0) {
#pragma unroll
            for (int a = 0; a < 2; ++a)
#pragma unroll
                for (int m = 0; m < 4; ++m) ssq[a][m] = 0.f;
        }
        f32x4 gv[2][2];
#pragma unroll
        for (int bj = 0; bj < 2; ++bj)
#pragma unroll
            for (int n = 0; n < 2; ++n) gv[bj][n] = *(const f32x4*)(gate + bb * D + col0 + bj * HALF + n * 16);
#pragma unroll
        for (int ai = 0; ai < 2; ++ai)
#pragma unroll
            for (int m = 0; m < 4; ++m) {
                const int lr = ai * HALF + wr * 64 + m * 16 + fr;
                const float* xr = xb + (size_t)lr * D + col0; float* orow = ob + (size_t)lr * D + col0;
                f32x4 xv[2][2];
#pragma unroll
                for (int bj = 0; bj < 2; ++bj)
#pragma unroll
                    for (int n = 0; n < 2; ++n) xv[bj][n] = *(const f32x4*)(xr + bj * HALF + n * 16);
                float s = ssq[ai][m];
#pragma unroll
                for (int bj = 0; bj < 2; ++bj)
#pragma unroll
                    for (int n = 0; n < 2; ++n) { const f32x4 z = xv[bj][n] + gv[bj][n] * acc[ai][bj][m][n]; *(f32x4*)(orow + bj * HALF + n * 16) = z; s += (z[0] * z[0] + z[1] * z[1]) + (z[2] * z[2] + z[3] * z[3]); }
                ssq[ai][m] = s;
            }
        if (u.pn == 3) {
#pragma unroll
            for (int ai = 0; ai < 2; ++ai)
#pragma unroll
                for (int m = 0; m < 4; ++m) { float s = ssq[ai][m]; s += __shfl_xor(s, 16); s += __shfl_xor(s, 32); if (fq == 0) red[(ai * HALF + wr * 64 + m * 16 + fr) * 4 + wc] = s; }
            __builtin_amdgcn_fence(__ATOMIC_RELEASE, "workgroup");
            asm volatile("s_waitcnt vmcnt(0) lgkmcnt(0)" ::: "memory");
            __builtin_amdgcn_s_barrier(); asm volatile("" ::: "memory");
            __builtin_amdgcn_s_barrier(); asm volatile("" ::: "memory");
            __builtin_amdgcn_fence(__ATOMIC_ACQUIRE, "workgroup");
            const f32x4* fg4 = (const f32x4*)fg;
            f32x4 fgv[4];
#pragma unroll
            for (int j = 0; j < 4; ++j) fgv[j] = fg4[lane + 64 * j];
            for (int i = 0; i < 32; i += 2) {
                const int lr = wid * 32 + i;
                f32x4* o0 = (f32x4*)(ob + (size_t)lr * D); f32x4* o1 = o0 + 256;
                f32x4 v0[4], v1[4];
#pragma unroll
                for (int j = 0; j < 4; ++j) { v0[j] = o0[lane + 64 * j]; v1[j] = o1[lane + 64 * j]; }
                const f32x4 r0 = *(const LAS f32x4*)(red + lr * 4), r1 = *(const LAS f32x4*)(red + lr * 4 + 4);
                const float rs0 = rsqrtf(((r0[0] + r0[1]) + (r0[2] + r0[3])) * (1.0f / D) + 1e-6f), rs1 = rsqrtf(((r1[0] + r1[1]) + (r1[2] + r1[3])) * (1.0f / D) + 1e-6f);
#pragma unroll
                for (int j = 0; j < 4; ++j) { o0[lane + 64 * j] = v0[j] * rs0 * fgv[j]; o1[lane + 64 * j] = v1[j] * rs1 * fgv[j]; }
            }
        }
    }
};

__device__ __forceinline__ void p0_mod_item(const Params& p, LAS unsigned char* lds, int item) {
    const int tid = threadIdx.x, wid = tid >> 6, lane = tid & 63;
    const int cgp = item >> 2, kc = item & 3;
    LAS float* s = (LAS float*)lds;
    LAS float* wp = (LAS float*)(lds + 40960);
    for (int idx = tid; idx < NB * 256; idx += 512) {
        const int b = idx >> 8, kk = idx & 255;
        const float c = b < 8 ? p.cp[b * D + kc * 256 + kk] : p.cs[(b - 8) * D + kc * 256 + kk];
        s[kk * NB + b] = silu_f(c);
    }
    __syncthreads();
    const int col = cgp * 64 + lane;
    const float* wbase = p.w_ada + (size_t)(kc * 256 + wid * 32) * 3072 + col;
    float wv[32];
#pragma unroll
    for (int kk = 0; kk < 32; ++kk) wv[kk] = wbase[(size_t)kk * 3072];
    float acc[NB];
#pragma unroll
    for (int b = 0; b < NB; ++b) acc[b] = 0.f;
#pragma unroll
    for (int kk = 0; kk < 32; ++kk) {
        const LAS f32x4* sr = (const LAS f32x4*)(s + (wid * 32 + kk) * NB);
#pragma unroll
        for (int b4 = 0; b4 < NB / 4; ++b4) { const f32x4 sv = sr[b4];
            acc[b4 * 4 + 0] += sv[0] * wv[kk]; acc[b4 * 4 + 1] += sv[1] * wv[kk]; acc[b4 * 4 + 2] += sv[2] * wv[kk]; acc[b4 * 4 + 3] += sv[3] * wv[kk]; }
    }
#pragma unroll
    for (int b = 0; b < NB; ++b) wp[(wid * NB + b) * 64 + lane] = acc[b];
    __syncthreads();
    float* modp = (float*)(p.ws + WS_MODP);
    for (int idx = tid; idx < NB * 64; idx += 512) {
        const int b = idx >> 6, l = idx & 63; float t = 0.f;
#pragma unroll
        for (int w = 0; w < 8; ++w) t += wp[(w * NB + b) * 64 + l];
        modp[((size_t)kc * NB + b) * 3072 + cgp * 64 + l] = t;
    }
}
__device__ __forceinline__ size_t bt2f_elem(int col, int k) {
    const int wv = col >> 7, c7 = col & 127, np = c7 >> 5, c5 = c7 & 31, fq = c5 >> 3, nlo = (c5 >> 2) & 1, j = c5 & 3;
    const int n = np * 2 + nlo, frb = fq * 4 + j, nb = wv * 8 + n, kb = k >> 5, fqk = (k >> 3) & 3, e = k & 7;
    return ((size_t)((nb * 32 + kb) * 64 + fqk * 16 + frb)) * 8 + e;
}
template <bool PERM>
__device__ __forceinline__ void p0_transpose_item(const float* W, int N, bf16_t* Bt, LAS unsigned char* lds, int item) {
    const int tid = threadIdx.x; const int nct = N >> 6, kb = item / nct, cb = item % nct, k0 = kb * 64, c0 = cb * 64;
    LAS float* tile = (LAS float*)lds;
#pragma unroll
    for (int i = 0; i < 8; ++i) { const int idx = i * 512 + tid, kk = idx >> 6, cc = idx & 63; tile[kk * 65 + cc] = W[(size_t)(k0 + kk) * N + c0 + cc]; }
    __syncthreads();
#pragma unroll
    for (int i = 0; i < 4; ++i) { const int idx = i * 512 + tid, cc = idx >> 5, kp = idx & 31;
        const int col = c0 + cc;
        const size_t off = PERM ? (size_t)bt1_row(col) * D + k0 + 2 * kp : bt2f_elem(col, k0 + 2 * kp);
        *(unsigned*)(Bt + off) = pk_bf16(tile[(2 * kp) * 65 + cc], tile[(2 * kp + 1) * 65 + cc]); }
}
__device__ __forceinline__ void phase0(const Params& p, LAS unsigned char* lds) {
    constexpr int N_MOD = 192, N_T1 = 16 * (INC / 64), N_T2 = 16 * (D / 64);
    for (int it = blockIdx.x; it < N_MOD + N_T1 + N_T2; it += gridDim.x) {
        if (it < N_MOD) p0_mod_item(p, lds, it);
        else if (it < N_MOD + N_T1) p0_transpose_item<true>(p.w_in, INC, (bf16_t*)(p.ws + WS_BT1), lds, it - N_MOD);
        else p0_transpose_item<false>(p.w_out, D, (bf16_t*)(p.ws + WS_BT2), lds, it - N_MOD - N_T1);
        __syncthreads();
    }
}

__device__ __forceinline__ void phase1(const Params& p, LAS unsigned char* lds) {
    const int tid = threadIdx.x, wid = tid >> 6, lane = tid & 63;
    LAS float* cA = (LAS float*)lds; LAS float* cB = cA + D;
    const float* modp = (const float*)(p.ws + WS_MODP);
    float* gate = (float*)(p.ws + WS_GATE);
    bf16_t* H = (bf16_t*)(p.ws + WS_H);
    for (int chunk_ = blockIdx.x; chunk_ < REP_P1 * (T_TOK / 512); chunk_ += gridDim.x) {
        const int chunk = chunk_ % (T_TOK / 512); const int row0 = chunk * 512;
        const int bb = row0 < T_PROMPT ? (row0 >> 13) : 8 + ((row0 - T_PROMPT) >> 11);
        const bool first = row0 < T_PROMPT ? ((row0 & 8191) == 0) : (((row0 - T_PROMPT) & 2047) == 0);
        __syncthreads();
        for (int j = tid; j < D; j += 512) {
            float sh = p.b_ada[j], sc = p.b_ada[D + j];
#pragma unroll
            for (int q = 0; q < 4; ++q) { sh += modp[((size_t)q * NB + bb) * 3072 + j]; sc += modp[((size_t)q * NB + bb) * 3072 + D + j]; }
            cA[j] = p.norm_g[j] * (1.0f + sc); cB[j] = sh;
            if (first) { float gt = p.b_ada[2 * D + j];
#pragma unroll
                for (int q = 0; q < 4; ++q) gt += modp[((size_t)q * NB + bb) * 3072 + 2 * D + j];
                gate[bb * D + j] = gt; }
        }
        __syncthreads();
        const float* xb = row0 < T_PROMPT ? p.xp + (size_t)row0 * D : p.xs + (size_t)(row0 - T_PROMPT) * D;
        f32x4 a4[4], b4[4];
#pragma unroll
        for (int j = 0; j < 4; ++j) { a4[j] = *(const LAS f32x4*)(cA + (lane + 64 * j) * 4); b4[j] = *(const LAS f32x4*)(cB + (lane + 64 * j) * 4); }
        for (int r = 0; r < 64; r += 2) {
            const int lr = wid * 64 + r;
            const f32x4* x0 = (const f32x4*)(xb + (size_t)lr * D); const f32x4* x1 = x0 + 256;
            f32x4 v0[4], v1[4]; float s0 = 0.f, s1 = 0.f;
#pragma unroll
            for (int j = 0; j < 4; ++j) { v0[j] = x0[lane + 64 * j]; v1[j] = x1[lane + 64 * j]; }
#pragma unroll
            for (int j = 0; j < 4; ++j) { s0 += (v0[j][0] * v0[j][0] + v0[j][1] * v0[j][1]) + (v0[j][2] * v0[j][2] + v0[j][3] * v0[j][3]); s1 += (v1[j][0] * v1[j][0] + v1[j][1] * v1[j][1]) + (v1[j][2] * v1[j][2] + v1[j][3] * v1[j][3]); }
            const float rs0 = rsqrtf(wave_sum(s0) * (1.0f / D) + 1e-6f), rs1 = rsqrtf(wave_sum(s1) * (1.0f / D) + 1e-6f);
            u32x2* h0 = (u32x2*)(H + (size_t)(row0 + lr) * D); u32x2* h1 = h0 + 256;
#pragma unroll
            for (int j = 0; j < 4; ++j) {
                const f32x4 y0 = v0[j] * rs0 * a4[j] + b4[j], y1 = v1[j] * rs1 * a4[j] + b4[j];
                u32x2 w0, w1; w0.x = pk_bf16(y0[0], y0[1]); w0.y = pk_bf16(y0[2], y0[3]); w1.x = pk_bf16(y1[0], y1[1]); w1.y = pk_bf16(y1[2], y1[3]);
                h0[lane + 64 * j] = w0; h1[lane + 64 * j] = w1;
            }
        }
    }
}

constexpr int TR = 16;
constexpr int TT = 2 * TR;
__device__ __forceinline__ void phase3(const Params& p, LAS unsigned char* lds) {
    const int tid = threadIdx.x, wid = tid >> 6, lane = tid & 63;
    const unsigned* Gu = (const unsigned*)(p.ws + WS_G);
    unsigned* Yu = (unsigned*)(p.ws + WS_Y);
    const int cgp = wid & 3, th = wid >> 2, dcol = cgp * 64 + lane, chB = 2 * dcol;
    f32x2 wB[31];
#pragma unroll
    for (int k = 0; k < 31; ++k) wB[k] = *(const f32x2*)(p.conv_b + k * 512 + chB);
    const f32x2 bias = *(const f32x2*)(p.conv_bb + chB), lg = *(const f32x2*)(p.ln_g + chB), lb = *(const f32x2*)(p.ln_b + chB);
    LAS f32x2* st = (LAS f32x2*)(lds + wid * (TR * 66 * 8));
    LAS f32x2* ms = (LAS f32x2*)(lds + 8 * (TR * 66 * 8) + wid * 512);
    const int dcA = tid & 255, thA = tid >> 8, chA = 2 * dcA;
    const f32x2 wa0 = *(const f32x2*)(p.conv_a + chA), wa1 = *(const f32x2*)(p.conv_a + 512 + chA), wa2 = *(const f32x2*)(p.conv_a + 1024 + chA);
    for (int tile_ = blockIdx.x; tile_ < REP_P3 * (T_TOK / TT); tile_ += gridDim.x) {
        const int tile = tile_ % (T_TOK / TT); const int t0 = tile * TT;
        const int L = t0 < T_PROMPT ? 8192 : 2048, seq_lo = t0 & ~(L - 1), seq_hi = seq_lo + L;
        {
            const int tb = t0 + th * TR;
            unsigned uw[TR + 30];
#pragma unroll
            for (int i = 0; i < TR + 30; ++i) { const int tok = tb - 15 + i; uw[i] = (tok >= seq_lo && tok < seq_hi) ? Gu[(size_t)tok * 1024 + 512 + dcol] : 0u; }
            f32x2 cb[TR];
#pragma unroll
            for (int i = 0; i < TR; ++i) {
                f32x2 a = bias;
#pragma unroll
                for (int k = 0; k < 31; ++k) a = __builtin_elementwise_fma(wB[k], unpk_bf16(uw[i + k]), a);
                cb[i] = a;
            }
#pragma unroll
            for (int i = 0; i < TR; ++i) { f32x2 sq; sq.x = cb[i].x + cb[i].y; sq.y = cb[i].x * cb[i].x + cb[i].y * cb[i].y; st[i * 66 + lane] = sq; }
            asm volatile("s_waitcnt lgkmcnt(0)" ::: "memory");
            {
                const int tk = lane & (TR - 1), hd = (lane >> 5);
                const LAS f32x4* rp = (const LAS f32x4*)(st + tk * 66 + hd * 32);
                float S = 0.f, Q = 0.f;
#pragma unroll
                for (int e = 0; e < 16; ++e) { const f32x4 v = rp[e]; S += v[0] + v[2]; Q += v[1] + v[3]; }
                const float mean = S * (1.0f / 64.0f), var = Q * (1.0f / 64.0f) - mean * mean;
                f32x2 mr; mr.x = mean; mr.y = rsqrtf(fmaxf(var, 0.f) + 1e-5f);
                if ((lane & 31) < TR) ms[hd * 32 + tk] = mr;
            }
            asm volatile("s_waitcnt lgkmcnt(0)" ::: "memory");
#pragma unroll
            for (int i = 0; i < TR; ++i) {
                const int tok = tb + i;
                const f32x2 mr = ms[(lane >> 5) * 32 + i];
                const f32x2 szv = unpk_bf16(Gu[(size_t)tok * 1024 + 768 + dcol]);
                f32x2 y = (cb[i] - mr.x) * mr.y * lg + lb;
                y.x = silu_f(y.x) * szv.x; y.y = silu_f(y.y) * szv.y;
                Yu[(size_t)tok * 512 + 256 + dcol] = pk_bf16(y.x, y.y);
            }
            asm volatile("s_waitcnt lgkmcnt(0)" ::: "memory");
        }
        {
            const int tb = t0 + thA * TR;
            unsigned qw[TR + 2];
#pragma unroll
            for (int i = 0; i < TR + 2; ++i) { const int tok = tb - 1 + i; qw[i] = (tok >= seq_lo && tok < seq_hi) ? Gu[(size_t)tok * 1024 + dcA] : 0u; }
#pragma unroll
            for (int i = 0; i < TR; ++i) {
                const int tok = tb + i;
                const f32x2 gg = unpk_bf16(Gu[(size_t)tok * 1024 + 256 + dcA]);
                const f32x2 cv = wa0 * unpk_bf16(qw[i]) + wa1 * unpk_bf16(qw[i + 1]) + wa2 * unpk_bf16(qw[i + 2]);
                const f32x2 y = gg * cv;
                Yu[(size_t)tok * 512 + dcA] = pk_bf16(y.x, y.y);
            }
        }
    }
}


constexpr int P4_RED = 131072;
constexpr int P4_NT = T_TOK / 64;
__device__ __forceinline__ void phase4(const Params& p, LAS unsigned char* lds) {
    const int tid = threadIdx.x, wid = __builtin_amdgcn_readfirstlane(tid >> 6), lane = tid & 63, fr = lane & 15, fq = lane >> 4;
    const bf16_t* Y = (const bf16_t*)(p.ws + WS_Y);
    const bf16x8* Bf = (const bf16x8*)(p.ws + WS_BT2) + (size_t)wid * 8 * 32 * 64 + lane;
    const float* gate = (const float*)(p.ws + WS_GATE);
    LAS float* red = (LAS float*)(lds + P4_RED);
    const int sb = lane * 16, swz = sb ^ (((sb >> 9) & 1) << 5), r_l = swz >> 6, c_l = (swz & 63) >> 1;
    const int aoff = fr * 64 + ((fq * 16) ^ ((fr >> 3) << 5));
    const int colw = wid * 128 + fq * 8;
#define P4_DMA(t0_) do { _Pragma("unroll") for (int _i = 0; _i < 16; ++_i) { const int chunk = wid * 16 + _i, kt = chunk >> 3, st = chunk & 7, R = (st >> 1) * 16 + r_l, C = (st & 1) * 32 + c_l; \
        __builtin_amdgcn_global_load_lds((const unsigned*)(Y + (size_t)((t0_) + R) * D + kt * 64 + C), (LAS unsigned*)(lds + chunk * 1024), 16, 0, 0); } } while (0)
    int tile = blockIdx.x;
    if (tile >= REP_P4 * P4_NT) return;
    P4_DMA((tile % P4_NT) * 64);
    for (; tile < REP_P4 * P4_NT; tile += gridDim.x) {
        const int t0 = (tile % P4_NT) * 64;
        asm volatile("s_waitcnt vmcnt(0)" ::: "memory"); __builtin_amdgcn_s_barrier(); asm volatile("" ::: "memory");
        f32x4 acc[4][8];
#pragma unroll
        for (int m = 0; m < 4; ++m)
#pragma unroll
            for (int n = 0; n < 8; ++n) acc[m][n] = (f32x4){0.f, 0.f, 0.f, 0.f};
        bf16x8 b0[8], b1[8], a[4];
#pragma unroll
        for (int n = 0; n < 8; ++n) b0[n] = Bf[(size_t)(n * 32) * 64];
#pragma unroll 1
        for (int kb = 0; kb < 32; kb += 2) {
#pragma unroll
            for (int n = 0; n < 8; ++n) b1[n] = Bf[(size_t)(n * 32 + kb + 1) * 64];
#pragma unroll
            for (int m = 0; m < 4; ++m) a[m] = *(const LAS bf16x8*)(lds + (kb >> 1) * 8192 + (m * 2) * 1024 + aoff);
#pragma unroll
            for (int m = 0; m < 4; ++m)
#pragma unroll
                for (int n = 0; n < 8; ++n) acc[m][n] = __builtin_amdgcn_mfma_f32_16x16x32_bf16(b0[n], a[m], acc[m][n], 0, 0, 0);
            const int kn = (kb + 2) & 31;
#pragma unroll
            for (int n = 0; n < 8; ++n) b0[n] = Bf[(size_t)(n * 32 + kn) * 64];
#pragma unroll
            for (int m = 0; m < 4; ++m) a[m] = *(const LAS bf16x8*)(lds + (kb >> 1) * 8192 + (m * 2 + 1) * 1024 + aoff);
#pragma unroll
            for (int m = 0; m < 4; ++m)
#pragma unroll
                for (int n = 0; n < 8; ++n) acc[m][n] = __builtin_amdgcn_mfma_f32_16x16x32_bf16(b1[n], a[m], acc[m][n], 0, 0, 0);
        }
        asm volatile("s_waitcnt lgkmcnt(0)" ::: "memory"); __builtin_amdgcn_s_barrier(); asm volatile("" ::: "memory");
        { const int nx = tile + (int)gridDim.x; if (nx < REP_P4 * P4_NT) P4_DMA((nx % P4_NT) * 64); }
        const int bb = t0 < T_PROMPT ? (t0 >> 13) : 8 + ((t0 - T_PROMPT) >> 11);
        const float* xb = (t0 < T_PROMPT ? p.xp + (size_t)t0 * D : p.xs + (size_t)(t0 - T_PROMPT) * D) + colw;
        const float* gb = gate + bb * D + colw;
#pragma unroll
        for (int m = 0; m < 4; ++m) {
            const float* xr = xb + (size_t)(m * 16 + fr) * D; float s = 0.f;
#pragma unroll
            for (int np = 0; np < 4; ++np) {
                const f32x4 x0 = *(const f32x4*)(xr + np * 32), x1 = *(const f32x4*)(xr + np * 32 + 4);
                const f32x4 g0 = *(const f32x4*)(gb + np * 32), g1 = *(const f32x4*)(gb + np * 32 + 4);
                const f32x4 z0 = x0 + g0 * acc[m][2 * np], z1 = x1 + g1 * acc[m][2 * np + 1];
                acc[m][2 * np] = z0; acc[m][2 * np + 1] = z1;
                s += (z0[0] * z0[0] + z0[1] * z0[1]) + (z0[2] * z0[2] + z0[3] * z0[3]) + (z1[0] * z1[0] + z1[1] * z1[1]) + (z1[2] * z1[2] + z1[3] * z1[3]);
            }
            s += __shfl_xor(s, 16); s += __shfl_xor(s, 32);
            if (fq == 0) red[(m * 16 + fr) * 8 + wid] = s;
        }
        asm volatile("s_waitcnt lgkmcnt(0)" ::: "memory"); __builtin_amdgcn_s_barrier(); asm volatile("" ::: "memory");
        float* ob = p.out + (size_t)t0 * D + colw;
        const float* fgb = p.final_g + colw;
#pragma unroll
        for (int m = 0; m < 4; ++m) {
            const f32x4 ra = *(const LAS f32x4*)(red + (m * 16 + fr) * 8), rb = *(const LAS f32x4*)(red + (m * 16 + fr) * 8 + 4);
            const float rs = rsqrtf((((ra[0] + ra[1]) + (ra[2] + ra[3])) + ((rb[0] + rb[1]) + (rb[2] + rb[3]))) * (1.0f / D) + 1e-6f);
            float* orow = ob + (size_t)(m * 16 + fr) * D;
#pragma unroll
            for (int np = 0; np < 4; ++np) {
                const f32x4 f0 = *(const f32x4*)(fgb + np * 32), f1 = *(const f32x4*)(fgb + np * 32 + 4);
                *(f32x4*)(orow + np * 32) = acc[m][2 * np] * rs * f0; *(f32x4*)(orow + np * 32 + 4) = acc[m][2 * np + 1] * rs * f1;
            }
        }
    }
#undef P4_DMA
}
__global__ void __launch_bounds__(512, 2) fwd_kernel(Params p) {
    extern __shared__ __attribute__((aligned(16))) unsigned char shm[];
    LAS unsigned char* lds = (LAS unsigned char*)shm;
    cg::grid_group grid = cg::this_grid();
    phase0(p, lds);
    grid.sync();
    phase1(p, lds);
    grid.sync();
    {
        Gemm g; g.A = (const bf16_t*)(p.ws + WS_H); g.Bt = (const bf16_t*)(p.ws + WS_BT1); g.M = T_TOK; g.N = INC; g.K = D;
        StaticOrder S; S.init(T_TOK, INC, (int)gridDim.x, (int)blockIdx.x);
        EpiGate E; E.G = (bf16_t*)(p.ws + WS_G);
        gemm_phase(lds, g, S, E);
    }
    grid.sync();
    phase3(p, lds);
    grid.sync();
    phase4(p, lds);
}

extern "C" void kernel_launch(void* const* d_in, const int* in_sizes, int n_in, void* d_out, int out_size, void* d_ws, size_t ws_size, hipStream_t stream) {
    static int grid_blocks = 0;
    if (grid_blocks == 0) {
        if (n_in != 15 || ws_size < WS_END) { fprintf(stderr, "kernel_launch: unexpected n_in %d / ws_size %zu (need %zu)\n", n_in, ws_size, (size_t)WS_END); grid_blocks = -1; return; }
        int dev = 0, cus = 0, per_cu = 0;
        (void)hipGetDevice(&dev);
        (void)hipDeviceGetAttribute(&cus, hipDeviceAttributeMultiprocessorCount, dev);
        if (hipFuncSetAttribute((const void*)fwd_kernel, hipFuncAttributeMaxDynamicSharedMemorySize, LDS_BYTES) != hipSuccess) { fprintf(stderr, "kernel_launch: hipFuncSetAttribute failed\n"); grid_blocks = -1; return; }
        if (hipOccupancyMaxActiveBlocksPerMultiprocessor(&per_cu, (const void*)fwd_kernel, 512, LDS_BYTES) != hipSuccess || per_cu < 1) { fprintf(stderr, "kernel_launch: occupancy query failed (%d)\n", per_cu); (void)hipGetLastError(); per_cu = 1; }
        grid_blocks = cus * 1;
        fprintf(stderr, "kernel_launch: cus %d per_cu %d grid %d\n", cus, per_cu, grid_blocks);
    }
    if (grid_blocks < 0) return;
    Params p{};
    p.xp = (const float*)d_in[0]; p.xs = (const float*)d_in[1]; p.cp = (const float*)d_in[2]; p.cs = (const float*)d_in[3];
    p.norm_g = (const float*)d_in[4]; p.w_ada = (const float*)d_in[5]; p.b_ada = (const float*)d_in[6]; p.w_in = (const float*)d_in[7];
    p.conv_a = (const float*)d_in[8]; p.conv_b = (const float*)d_in[9]; p.conv_bb = (const float*)d_in[10]; p.ln_g = (const float*)d_in[11];
    p.ln_b = (const float*)d_in[12]; p.w_out = (const float*)d_in[13]; p.final_g = (const float*)d_in[14];
    p.out = (float*)d_out; p.ws = (unsigned char*)d_ws;
    void* args[] = {&p};
    hipError_t e = hipLaunchCooperativeKernel((const void*)fwd_kernel, dim3(grid_blocks), dim3(512), args, LDS_BYTES, stream);
    if (e != hipSuccess) fprintf(stderr, "cooperative launch failed: %s (grid %d)\n", hipGetErrorString(e), grid_blocks);
}
```
